# Optimizing an MI355X kernel written in HIP

```python
import jax, jax.numpy as jnp
from jax import lax
import numpy as np

D_MODEL = 1024
BATCH = 8
SEQ = 2048
DEPTH = 4

CONV_WIDTH = D_MODEL // 2
CONV_HEADS = 8
CONV_K = 3
POOL_WIDTH = D_MODEL // 2
POOL_WINDOWS = (2, 4, 8, 16)
POOL_GROUPS = len(POOL_WINDOWS)
POOL_GROUP_DIM = POOL_WIDTH // POOL_GROUPS
MIX_WIDTH = CONV_WIDTH + POOL_WIDTH
IN_COLS = 4 * CONV_WIDTH + 2 * POOL_WIDTH
NORM_EPS = 1e-6

kernel_name = "hybrid_shortconv_pool_parallel_adaln"


def rms_norm(x, g):
    xf = x.astype(jnp.float32)
    y = xf * lax.rsqrt(jnp.mean(xf * xf, axis=-1, keepdims=True) + NORM_EPS)
    return (y * g.astype(jnp.float32)).astype(x.dtype)


def causal_depthwise_conv(z, w):
    C = z.shape[-1]
    return lax.conv_general_dilated(
        z, w[:, None, :].astype(z.dtype),
        window_strides=(1,), padding=[(CONV_K - 1, 0)],
        dimension_numbers=("NWC", "WIO", "NWC"),
        feature_group_count=C)


def causal_multiscale_pool(p, w_pool, pool_scale):
    B, T, _ = p.shape
    pf = p.astype(jnp.float32)
    pos = jnp.arange(1, T + 1, dtype=jnp.float32)[None, :, None]
    outs = []
    for g, w in enumerate(POOL_WINDOWS):
        pg = pf[..., g * POOL_GROUP_DIM:(g + 1) * POOL_GROUP_DIM]
        s = jnp.cumsum(pg, axis=1)
        lag = jnp.pad(s, ((0, 0), (w, 0), (0, 0)))[:, :T]
        mean = (s - lag) / jnp.minimum(pos, float(w))
        outs.append(mean - pg)
    pooled = jnp.stack(outs, axis=2).astype(p.dtype)
    mixed = jnp.einsum("btgc,gcd->btgd", pooled, w_pool)
    return mixed.reshape(B, T, POOL_WIDTH) * pool_scale


def setup_inputs(seed: int = 0) -> dict:
    key = jax.random.key(seed)
    ks = jax.random.split(key, 12)
    f32 = jnp.float32
    x = jax.random.normal(ks[0], (BATCH, SEQ, D_MODEL), f32)
    c = jax.random.normal(ks[1], (BATCH, D_MODEL), f32)
    w_ada = jax.random.normal(ks[2], (DEPTH, D_MODEL, 3 * D_MODEL), f32) * D_MODEL ** -0.5
    b_ada = 0.01 * jax.random.normal(ks[3], (DEPTH, 3 * D_MODEL), f32)
    g_pre = 1.0 + 0.02 * jax.random.normal(ks[4], (DEPTH, D_MODEL), f32)
    w_in = jax.random.normal(ks[5], (DEPTH, D_MODEL, IN_COLS), f32) * D_MODEL ** -0.5
    w_conv = jax.random.normal(ks[6], (DEPTH, CONV_K, CONV_WIDTH), f32) * CONV_K ** -0.5
    w_pool = jax.random.normal(ks[7], (DEPTH, POOL_GROUPS, POOL_GROUP_DIM, POOL_GROUP_DIM), f32) * POOL_GROUP_DIM ** -0.5
    pool_scale = 1.0 + 0.1 * jax.random.normal(ks[8], (DEPTH, POOL_WIDTH), f32)
    w_out = jax.random.normal(ks[9], (DEPTH, MIX_WIDTH, D_MODEL), f32) * MIX_WIDTH ** -0.5
    g_post = 1.0 + 0.02 * jax.random.normal(ks[10], (DEPTH, D_MODEL), f32)
    return {"x": x, "c": c, "w_ada": w_ada, "b_ada": b_ada, "g_pre": g_pre, "w_in": w_in,
            "w_conv": w_conv, "w_pool": w_pool, "pool_scale": pool_scale,
            "w_out": w_out, "g_post": g_post}


def reference(x, c, w_ada, b_ada, g_pre, w_in, w_conv, w_pool, pool_scale, w_out, g_post):
    B, T, D = x.shape
    c_act = jax.nn.silu(c)
    cw = CONV_WIDTH
    for l in range(DEPTH):
        mod = c_act @ w_ada[l] + b_ada[l]
        shift, scale, gate = jnp.split(mod, 3, axis=-1)
        h = rms_norm(x, g_pre[l]) * (1.0 + scale[:, None, :]) + shift[:, None, :]
        proj = h @ w_in[l]
        u_a = proj[..., 0 * cw:1 * cw]
        b_a = proj[..., 1 * cw:2 * cw]
        c_a = proj[..., 2 * cw:3 * cw]
        gate_a = proj[..., 3 * cw:4 * cw]
        o = 4 * cw
        u_p = proj[..., o:o + POOL_WIDTH]
        gate_p = proj[..., o + POOL_WIDTH:o + 2 * POOL_WIDTH]
        y_a = b_a * causal_depthwise_conv(c_a * u_a, w_conv[l]) * jax.nn.silu(gate_a)
        y_p = causal_multiscale_pool(u_p, w_pool[l], pool_scale[l]) * jax.nn.silu(gate_p)
        y = jnp.concatenate([y_a, y_p], axis=-1) @ w_out[l]
        x = x + gate[:, None, :] * rms_norm(y, g_post[l])
    return x
```

```cpp
#include <hip/hip_runtime.h>
#include <cstdio>

namespace {
constexpr int D = 1024, B = 8, T = 2048, L = 4, M = B * T, NIN = 3072, CW = 512, PW = 512, PG = 4, PGD = 128;
constexpr float EPS = 1e-6f;

__device__ __forceinline__ float silu_f(float v) { return v / (1.0f + __expf(-v)); }

__global__ void k_mod(const float* __restrict__ c, const float* __restrict__ w_ada, const float* __restrict__ b_ada, float* __restrict__ mod) {
    const int n = blockIdx.x * 256 + threadIdx.x, l = blockIdx.y;
    float acc[B];
#pragma unroll
    for (int b = 0; b < B; ++b) acc[b] = 0.f;
    const float* w = w_ada + (size_t)l * D * NIN + n;
    for (int k = 0; k < D; ++k) {
        const float wv = w[(size_t)k * NIN];
#pragma unroll
        for (int b = 0; b < B; ++b) acc[b] += silu_f(c[b * D + k]) * wv;
    }
#pragma unroll
    for (int b = 0; b < B; ++b) mod[((size_t)l * B + b) * NIN + n] = acc[b] + b_ada[l * NIN + n];
}

__device__ __forceinline__ float block_sum_256(float v, float* red) {
#pragma unroll
    for (int o = 32; o > 0; o >>= 1) v += __shfl_xor(v, o);
    __syncthreads();
    if ((threadIdx.x & 63) == 0) red[threadIdx.x >> 6] = v;
    __syncthreads();
    return red[0] + red[1] + red[2] + red[3];
}

__global__ void k_prenorm(const float* __restrict__ x, const float* __restrict__ g, const float* __restrict__ mod_l, float* __restrict__ h) {
    __shared__ float red[4];
    const int m = blockIdx.x, b = m / T;
    const float* xr = x + (size_t)m * D;
    float v[4], s = 0.f;
#pragma unroll
    for (int j = 0; j < 4; ++j) { v[j] = xr[threadIdx.x + 256 * j]; s += v[j] * v[j]; }
    const float tot = block_sum_256(s, red);
    const float rstd = rsqrtf(tot / D + EPS);
    const float* mb = mod_l + (size_t)b * NIN;
#pragma unroll
    for (int j = 0; j < 4; ++j) { const int cidx = threadIdx.x + 256 * j; h[(size_t)m * D + cidx] = v[j] * rstd * g[cidx] * (1.0f + mb[D + cidx]) + mb[cidx]; }
}

__global__ void __launch_bounds__(256) k_sgemm(const float* __restrict__ A, const float* __restrict__ Bm, float* __restrict__ C, int Mm, int Nn, int Kk) {
    __shared__ float As[16][64 + 4];
    __shared__ float Bs[16][64 + 4];
    const int tx = threadIdx.x & 15, ty = threadIdx.x >> 4;
    const int row0 = blockIdx.y * 64, col0 = blockIdx.x * 64;
    float acc[4][4];
#pragma unroll
    for (int i = 0; i < 4; ++i)
#pragma unroll
        for (int j = 0; j < 4; ++j) acc[i][j] = 0.f;
    for (int k0 = 0; k0 < Kk; k0 += 16) {
        {
            const int r = threadIdx.x >> 2, kq = (threadIdx.x & 3) * 4;
            const float4 a = *(const float4*)(A + (size_t)(row0 + r) * Kk + k0 + kq);
            As[kq + 0][r] = a.x; As[kq + 1][r] = a.y; As[kq + 2][r] = a.z; As[kq + 3][r] = a.w;
            const int kr = threadIdx.x >> 4, cq = (threadIdx.x & 15) * 4;
            const float4 bv = *(const float4*)(Bm + (size_t)(k0 + kr) * Nn + col0 + cq);
            Bs[kr][cq + 0] = bv.x; Bs[kr][cq + 1] = bv.y; Bs[kr][cq + 2] = bv.z; Bs[kr][cq + 3] = bv.w;
        }
        __syncthreads();
#pragma unroll
        for (int k = 0; k < 16; ++k) {
            float a[4], bb[4];
#pragma unroll
            for (int i = 0; i < 4; ++i) { a[i] = As[k][ty * 4 + i]; bb[i] = Bs[k][tx * 4 + i]; }
#pragma unroll
            for (int i = 0; i < 4; ++i)
#pragma unroll
                for (int j = 0; j < 4; ++j) acc[i][j] += a[i] * bb[j];
        }
        __syncthreads();
    }
#pragma unroll
    for (int i = 0; i < 4; ++i) *(float4*)(C + (size_t)(row0 + ty * 4 + i) * Nn + col0 + tx * 4) = make_float4(acc[i][0], acc[i][1], acc[i][2], acc[i][3]);
}

__global__ void k_mix1(const float* __restrict__ proj, const float* __restrict__ w_conv_l, float* __restrict__ ycat, float* __restrict__ pooled) {
    const int m = blockIdx.x, t = m % T;
    for (int c = threadIdx.x; c < D; c += 256) {
        const float* pr = proj + (size_t)m * NIN;
        if (c < CW) {
            float conv = 0.f;
#pragma unroll
            for (int k = 0; k < 3; ++k) { const int tt = t - 2 + k; if (tt >= 0) { const float* pq = proj + (size_t)(m - 2 + k) * NIN; conv += w_conv_l[k * CW + c] * pq[2 * CW + c] * pq[c]; } }
            ycat[(size_t)m * D + c] = pr[CW + c] * conv * silu_f(pr[3 * CW + c]);
        } else {
            const int cp = c - CW, g = cp / PGD, w = 2 << g;
            float s = 0.f; int cnt = 0;
            for (int k = 0; k < w; ++k) { if (t - k >= 0) { s += proj[(size_t)(m - k) * NIN + 4 * CW + cp]; ++cnt; } }
            pooled[(size_t)m * PW + cp] = s / (float)cnt - pr[4 * CW + cp];
        }
    }
}
__global__ void k_mix2(const float* __restrict__ proj, const float* __restrict__ pooled, const float* __restrict__ w_pool_l, const float* __restrict__ ps_l, float* __restrict__ ycat) {
    __shared__ float pl[PW];
    const int m = blockIdx.x;
    for (int c = threadIdx.x; c < PW; c += 256) pl[c] = pooled[(size_t)m * PW + c];
    __syncthreads();
    for (int d = threadIdx.x; d < PW; d += 256) {
        const int g = d / PGD, dl = d % PGD;
        const float* wp = w_pool_l + (size_t)g * PGD * PGD + dl;
        float s = 0.f;
        for (int c = 0; c < PGD; ++c) s += pl[g * PGD + c] * wp[(size_t)c * PGD];
        ycat[(size_t)m * D + CW + d] = s * ps_l[d] * silu_f(proj[(size_t)m * NIN + 4 * CW + PW + d]);
    }
}
__global__ void k_post(const float* __restrict__ xin, const float* __restrict__ y, const float* __restrict__ g, const float* __restrict__ mod_l, float* __restrict__ xout) {
    __shared__ float red[4];
    const int m = blockIdx.x, b = m / T;
    const float* yr = y + (size_t)m * D;
    float v[4], s = 0.f;
#pragma unroll
    for (int j = 0; j < 4; ++j) { v[j] = yr[threadIdx.x + 256 * j]; s += v[j] * v[j]; }
    const float tot = block_sum_256(s, red);
    const float rstd = rsqrtf(tot / D + EPS);
    const float* mb = mod_l + (size_t)b * NIN + 2 * D;
#pragma unroll
    for (int j = 0; j < 4; ++j) { const int cidx = threadIdx.x + 256 * j; xout[(size_t)m * D + cidx] = xin[(size_t)m * D + cidx] + mb[cidx] * (v[j] * rstd * g[cidx]); }
}
}

extern "C" void kernel_launch(void* const* d_in, const int* in_sizes, int n_in, void* d_out, int out_size, void* d_ws, size_t ws_size, hipStream_t stream) {
    const float* x = (const float*)d_in[0]; const float* c = (const float*)d_in[1]; const float* w_ada = (const float*)d_in[2]; const float* b_ada = (const float*)d_in[3];
    const float* g_pre = (const float*)d_in[4]; const float* w_in = (const float*)d_in[5]; const float* w_conv = (const float*)d_in[6]; const float* w_pool = (const float*)d_in[7];
    const float* pool_scale = (const float*)d_in[8]; const float* w_out = (const float*)d_in[9]; const float* g_post = (const float*)d_in[10];
    float* out = (float*)d_out;
    char* ws = (char*)d_ws;
    constexpr int MH = M / 2;
    float* mod = (float*)ws;                         ws += (size_t)L * B * NIN * 4;
    float* h = (float*)ws;                           ws += (size_t)MH * D * 4;
    float* proj = (float*)ws;                        ws += (size_t)MH * NIN * 4;
    float* ycat = (float*)ws;                        ws += (size_t)MH * D * 4;
    float* pooled = (float*)ws;                      ws += (size_t)MH * PW * 4;
    k_mod<<<dim3(NIN / 256, L), 256, 0, stream>>>(c, w_ada, b_ada, mod);
    for (int l = 0; l < L; ++l) {
        const float* mod_l = mod + (size_t)l * B * NIN;
        for (int hf = 0; hf < 2; ++hf) {
            const float* xin = (l == 0 ? x : out) + (size_t)hf * MH * D;
            float* xo = out + (size_t)hf * MH * D;
            const float* mod_h = mod_l + (size_t)hf * (B / 2) * NIN;
            k_prenorm<<<MH, 256, 0, stream>>>(xin, g_pre + l * D, mod_h, h);
            k_sgemm<<<dim3(NIN / 64, MH / 64), 256, 0, stream>>>(h, w_in + (size_t)l * D * NIN, proj, MH, NIN, D);
            k_mix1<<<MH, 256, 0, stream>>>(proj, w_conv + (size_t)l * 3 * CW, ycat, pooled);
            k_mix2<<<MH, 256, 0, stream>>>(proj, pooled, w_pool + (size_t)l * PG * PGD * PGD, pool_scale + l * PW, ycat);
            k_sgemm<<<dim3(D / 64, MH / 64), 256, 0, stream>>>(ycat, w_out + (size_t)l * D * D, h, MH, D, D);
            k_post<<<MH, 256, 0, stream>>>(xin, h, g_post + l * D, mod_h, xo);
        }
    }
}
```
